# Optimizing an MI355X kernel written in HIP

```python
import math
import jax, jax.numpy as jnp
from jax import lax
import numpy as np

D_MODEL = 1024
BATCH = 8
SEQ = 4096
DEPTH = 2

HEAD_DIM = 64
GRID_W = 64
Q_BLOCK = 128
ROPE_THETA = 10000.0
MLA_HEADS = 6
MLA_Q_RANK = 256
MLA_KV_RANK = 128
MLA_NOPE_DIM = 64
MLA_ROPE_DIM = 32
MLA_V_DIM = 64
DIL_HEADS = 6
DIL_BRANCHES = ((128, 1), (512, 4), (2048, 16))
GQA_Q_HEADS = 4
GQA_KV_HEADS = 2
REL_BUCKETS = 32
REL_MAX_DIST = 1024
D_FF = -(-8 * D_MODEL // (3 * 256)) * 256
MLA_IN = MLA_Q_RANK + MLA_KV_RANK + MLA_ROPE_DIM
DIL_IN = 3 * DIL_HEADS * HEAD_DIM
GQA_IN = (GQA_Q_HEADS + 2 * GQA_KV_HEADS) * HEAD_DIM
IN_WIDTH = MLA_IN + DIL_IN + GQA_IN
MIX_WIDTH = MLA_HEADS * MLA_V_DIM + DIL_HEADS * HEAD_DIM + GQA_Q_HEADS * HEAD_DIM
DN_ALPHA = (2.0 * DEPTH) ** 0.25
DN_BETA = (8.0 * DEPTH) ** -0.25
NEG_INF = -1e30

kernel_name = "hybrid_mla_dilated_axialgqa_deepnorm_encoder"


def rms_norm(x, g, eps=1e-6):
    xf = x.astype(jnp.float32)
    y = xf * lax.rsqrt(jnp.mean(xf * xf, axis=-1, keepdims=True) + eps)
    return (y * g.astype(jnp.float32)).astype(x.dtype)


def layer_norm(x, g, b, eps=1e-5):
    xf = x.astype(jnp.float32)
    mu = jnp.mean(xf, axis=-1, keepdims=True)
    var = jnp.mean(jnp.square(xf - mu), axis=-1, keepdims=True)
    y = (xf - mu) * lax.rsqrt(var + eps)
    return (y * g.astype(jnp.float32) + b.astype(jnp.float32)).astype(x.dtype)


def rope(x, pos):
    d = x.shape[-1]
    inv = ROPE_THETA ** (-jnp.arange(0, d, 2, dtype=jnp.float32) / d)
    ang = pos[:, None] * inv[None, :]
    cos = jnp.cos(ang)[None, :, None, :]
    sin = jnp.sin(ang)[None, :, None, :]
    xf = x.astype(jnp.float32)
    x1, x2 = xf[..., : d // 2], xf[..., d // 2:]
    return jnp.concatenate([x1 * cos - x2 * sin, x1 * sin + x2 * cos], axis=-1).astype(x.dtype)


def t5_bucket(rel):
    nb = REL_BUCKETS // 2
    exact = nb // 2
    ret = jnp.where(rel > 0, nb, 0)
    n = jnp.abs(rel)
    nf = jnp.maximum(n, 1).astype(jnp.float32)
    large = exact + (jnp.log(nf / exact) / math.log(REL_MAX_DIST / exact) * (nb - exact)).astype(jnp.int32)
    large = jnp.minimum(large, nb - 1)
    return ret + jnp.where(n < exact, n, large)


def dense_attention(q, k, v, scale):
    B, S, H, Dk = q.shape
    Hkv, Dv = k.shape[2], v.shape[-1]
    G = H // Hkv
    nblk = S // Q_BLOCK
    qb = q.reshape(B, nblk, Q_BLOCK, Hkv, G, Dk).transpose(1, 0, 2, 3, 4, 5)

    def one_block(qblk):
        logits = jnp.einsum('bqkgd,bskd->bkgqs', qblk, k).astype(jnp.float32) * scale
        p = jax.nn.softmax(logits, axis=-1)
        return jnp.einsum('bkgqs,bskd->bqkgd', p.astype(v.dtype), v)

    o = lax.map(one_block, qb)
    return o.transpose(1, 0, 2, 3, 4, 5).reshape(B, S, H, Dv)


def dilated_branch(q, k, v, rel_bias, window, dil):
    B, S, H, D = q.shape
    half = window // (2 * dil)
    L = S // dil
    nb = -(-L // half)
    Lp = nb * half
    BB = B * dil

    def to_sub(t):
        return t.reshape(B, L, dil, H, D).transpose(0, 2, 1, 3, 4).reshape(BB, L, H, D)

    qs, ks, vs = to_sub(q), to_sub(k), to_sub(v)
    qb = jnp.pad(qs, ((0, 0), (0, Lp - L), (0, 0), (0, 0))).reshape(BB, nb, half, H, D)

    def band(t):
        tp = jnp.pad(t, ((0, 0), (half, Lp - L + half), (0, 0), (0, 0))).reshape(BB, nb + 2, half, H, D)
        return jnp.concatenate([tp[:, :-2], tp[:, 1:-1], tp[:, 2:]], axis=2)

    kb, vb = band(ks), band(vs)
    rel = jnp.arange(3 * half)[None, :] - half - jnp.arange(half)[:, None]
    bias = jnp.transpose(rel_bias[t5_bucket(rel * dil)], (2, 0, 1)).astype(jnp.float32)
    key_idx = jnp.arange(nb)[:, None] * half - half + jnp.arange(3 * half)[None, :]
    mask = (jnp.abs(rel) <= half)[None] & ((key_idx >= 0) & (key_idx < L))[:, None, :]

    logits = jnp.einsum('bnqhd,bnkhd->bnhqk', qb, kb).astype(jnp.float32) * (HEAD_DIM ** -0.5)
    logits = jnp.where(mask[None, :, None], logits + bias[None, None], NEG_INF)
    m = jnp.max(logits, axis=-1, keepdims=True)
    e = jnp.exp(logits - m)
    s = jnp.sum(e, axis=-1)
    o = jnp.einsum('bnhqk,bnkhd->bnqhd', e.astype(v.dtype), vb).astype(jnp.float32)
    o = o / jnp.transpose(s, (0, 1, 3, 2))[..., None]
    lse = jnp.transpose(m[..., 0] + jnp.log(s), (0, 1, 3, 2))
    o = o.reshape(BB, Lp, H, D)[:, :L]
    lse = lse.reshape(BB, Lp, H)[:, :L]
    o = o.reshape(B, dil, L, H, D).transpose(0, 2, 1, 3, 4).reshape(B, S, H, D)
    lse = lse.reshape(B, dil, L, H).transpose(0, 2, 1, 3).reshape(B, S, H)
    return o, lse


def dilated_mixture(q, k, v, rel_bias):
    outs, lses = [], []
    for window, dil in DIL_BRANCHES:
        o, lse = dilated_branch(q, k, v, rel_bias, window, dil)
        outs.append(o)
        lses.append(lse)
    w = jax.nn.softmax(jnp.stack(lses, axis=0), axis=0)
    o = jnp.sum(w[..., None] * jnp.stack(outs, axis=0), axis=0)
    return o.astype(q.dtype)


def setup_inputs(seed: int = 0) -> dict:
    key = jax.random.key(seed)
    ks = jax.random.split(key, 20)
    f32 = jnp.float32

    def nrm(k, shape, scale):
        return jax.random.normal(k, shape, f32) * scale

    def gain(k, shape):
        return 1.0 + 0.02 * jax.random.normal(k, shape, f32)

    return {
        "x": jax.random.normal(ks[0], (BATCH, SEQ, D_MODEL), f32),
        "w_in": nrm(ks[1], (DEPTH, D_MODEL, IN_WIDTH), D_MODEL ** -0.5),
        "mla_q_norm": gain(ks[2], (DEPTH, MLA_Q_RANK)),
        "mla_kv_norm": gain(ks[3], (DEPTH, MLA_KV_RANK)),
        "mla_w_uq": nrm(ks[4], (DEPTH, MLA_Q_RANK, MLA_HEADS * (MLA_NOPE_DIM + MLA_ROPE_DIM)), MLA_Q_RANK ** -0.5),
        "mla_w_ukv": nrm(ks[5], (DEPTH, MLA_KV_RANK, MLA_HEADS * (MLA_NOPE_DIM + MLA_V_DIM)), MLA_KV_RANK ** -0.5),
        "gqa_q_norm": gain(ks[6], (DEPTH, HEAD_DIM)),
        "gqa_k_norm": gain(ks[7], (DEPTH, HEAD_DIM)),
        "rel_bias": nrm(ks[8], (REL_BUCKETS, DIL_HEADS), 0.1),
        "w_out": nrm(ks[9], (DEPTH, MIX_WIDTH, D_MODEL), DN_BETA * MIX_WIDTH ** -0.5),
        "ln1_g": gain(ks[10], (DEPTH, D_MODEL)),
        "ln1_b": nrm(ks[11], (DEPTH, D_MODEL), 0.02),
        "ffn_w_gate": nrm(ks[12], (DEPTH, D_MODEL, D_FF), D_MODEL ** -0.5),
        "ffn_w_up": nrm(ks[13], (DEPTH, D_MODEL, D_FF), D_MODEL ** -0.5),
        "ffn_w_down": nrm(ks[14], (DEPTH, D_FF, D_MODEL), DN_BETA * D_FF ** -0.5),
        "ln2_g": gain(ks[15], (DEPTH, D_MODEL)),
        "ln2_b": nrm(ks[16], (DEPTH, D_MODEL), 0.02),
    }


def reference(x, w_in, mla_q_norm, mla_kv_norm, mla_w_uq, mla_w_ukv, gqa_q_norm, gqa_k_norm,
              rel_bias, w_out, ln1_g, ln1_b, ffn_w_gate, ffn_w_up, ffn_w_down, ln2_g, ln2_b):
    B, S, _ = x.shape
    rows = S // GRID_W
    pos = jnp.arange(S, dtype=jnp.float32)
    row_pos = jnp.repeat(jnp.arange(rows), GRID_W).astype(jnp.float32)
    col_pos = jnp.tile(jnp.arange(GRID_W), rows).astype(jnp.float32)
    half_rot = HEAD_DIM // 2

    for l in range(DEPTH):
        h = x @ w_in[l]
        o0 = 0
        cq = rms_norm(h[..., o0:o0 + MLA_Q_RANK], mla_q_norm[l]); o0 += MLA_Q_RANK
        ckv = rms_norm(h[..., o0:o0 + MLA_KV_RANK], mla_kv_norm[l]); o0 += MLA_KV_RANK
        k_rope = h[..., o0:o0 + MLA_ROPE_DIM][:, :, None, :]; o0 += MLA_ROPE_DIM
        qa = (cq @ mla_w_uq[l]).reshape(B, S, MLA_HEADS, MLA_NOPE_DIM + MLA_ROPE_DIM)
        qa = jnp.concatenate([qa[..., :MLA_NOPE_DIM], rope(qa[..., MLA_NOPE_DIM:], pos)], axis=-1)
        kva = (ckv @ mla_w_ukv[l]).reshape(B, S, MLA_HEADS, MLA_NOPE_DIM + MLA_V_DIM)
        k_rope = jnp.broadcast_to(rope(k_rope, pos), (B, S, MLA_HEADS, MLA_ROPE_DIM))
        ka = jnp.concatenate([kva[..., :MLA_NOPE_DIM], k_rope], axis=-1)
        va = kva[..., MLA_NOPE_DIM:]
        out_a = dense_attention(qa, ka, va, (MLA_NOPE_DIM + MLA_ROPE_DIM) ** -0.5)
        out_a = out_a.reshape(B, S, MLA_HEADS * MLA_V_DIM)
        hb = h[..., o0:o0 + DIL_IN].reshape(B, S, 3, DIL_HEADS, HEAD_DIM); o0 += DIL_IN
        out_b = dilated_mixture(hb[:, :, 0], hb[:, :, 1], hb[:, :, 2], rel_bias)
        out_b = out_b.reshape(B, S, DIL_HEADS * HEAD_DIM)
        nq, nkv = GQA_Q_HEADS * HEAD_DIM, GQA_KV_HEADS * HEAD_DIM
        qc = h[..., o0:o0 + nq].reshape(B, S, GQA_Q_HEADS, HEAD_DIM); o0 += nq
        kc = h[..., o0:o0 + nkv].reshape(B, S, GQA_KV_HEADS, HEAD_DIM); o0 += nkv
        vc = h[..., o0:o0 + nkv].reshape(B, S, GQA_KV_HEADS, HEAD_DIM); o0 += nkv
        qc = rms_norm(qc, gqa_q_norm[l])
        kc = rms_norm(kc, gqa_k_norm[l])
        qc = jnp.concatenate([rope(qc[..., :half_rot], row_pos), rope(qc[..., half_rot:], col_pos)], axis=-1)
        kc = jnp.concatenate([rope(kc[..., :half_rot], row_pos), rope(kc[..., half_rot:], col_pos)], axis=-1)
        out_c = dense_attention(qc, kc, vc, HEAD_DIM ** -0.5).reshape(B, S, GQA_Q_HEADS * HEAD_DIM)
        mix = jnp.concatenate([out_a, out_b, out_c], axis=-1) @ w_out[l]
        x = layer_norm(DN_ALPHA * x + mix, ln1_g[l], ln1_b[l])
        ff = (jax.nn.silu(x @ ffn_w_gate[l]) * (x @ ffn_w_up[l])) @ ffn_w_down[l]
        x = layer_norm(DN_ALPHA * x + ff, ln2_g[l], ln2_b[l])
    return x
```

```cpp
#include <hip/hip_runtime.h>
#include <hip/hip_cooperative_groups.h>
#include <cstdio>
#include <cstdint>
namespace cg = cooperative_groups;
namespace pg8 {
#define PG8_LAS __attribute__((address_space(3)))
typedef unsigned short bf16_t;
typedef short bf16x8 __attribute__((ext_vector_type(8)));
typedef float f32x4 __attribute__((ext_vector_type(4)));
typedef unsigned u32x4 __attribute__((ext_vector_type(4)));
constexpr int BM = 256, BK = 64, HALF = 128, HTB = HALF * BK * 2  , STAGE_BYTES = 8 * HTB, NXCD = 8, WGM = 8;

__host__ __device__ __forceinline__ int lds_byte(int r, int c) { const int st = (r >> 4) * 2 + (c >> 5), rr = r & 15, cc = c & 31, ob = rr * 64 + cc * 2; return st * 1024 + (ob ^ (((ob >> 9) & 1) << 5)); }
__host__ __device__ __forceinline__ void stage_rc(int b, int& R, int& C) { const int st = b / 1024, sb = b % 1024, swz = sb ^ (((sb >> 9) & 1) << 5); R = (st >> 1) * 16 + swz / 64; C = (st & 1) * 32 + (swz % 64) / 2; }
__host__ __device__ __forceinline__ int perm32(int rho) { const int n = rho >> 4, i = rho & 15; return 8 * (i >> 2) + 4 * n + (i & 3); }

struct Unit { int pm, pn; };
struct Gemm { const bf16_t* A; const bf16_t* Bt; int M, N, K, lda; };

struct StaticOrder {
    int nM, nN, nwg, G, c;
    __host__ __device__ void init(int M, int N, int G_, int c_) { nM = M / BM; nN = N / BM; nwg = nM * nN; G = G_; c = c_; }
    __host__ __device__ bool next(int i, Unit& u) const {
        const long L = (long)i * G + c; if (L >= nwg) return false;
        int wgid = (int)L; { const int q = nwg / NXCD, r = nwg % NXCD, xcd = wgid % NXCD, off = wgid / NXCD; wgid = (xcd < r ? xcd * (q + 1) : r * (q + 1) + (xcd - r) * q) + off; }
        const int nig = WGM * nN, gid = wgid / nig, fm = gid * WGM, gsz = (nM - fm) < WGM ? (nM - fm) : WGM;
        u.pm = fm + ((wgid % nig) % gsz); u.pn = (wgid % nig) / gsz; return true;
    }
};

typedef float f32x2 __attribute__((ext_vector_type(2)));
typedef __bf16 bf16x2_t __attribute__((ext_vector_type(2)));
__device__ __forceinline__ unsigned cvt_pk_bf16(float lo, float hi) { f32x2 v = {lo, hi}; bf16x2_t b = __builtin_convertvector(v, bf16x2_t); return __builtin_bit_cast(unsigned, b); }


template <class Epi, class Sched, bool ALIGN_EPI>
__device__ __forceinline__ void gemm_phase(PG8_LAS unsigned char* lds, const Gemm g, const Sched& S, const Epi& E) {
    int tid = threadIdx.x; asm volatile("" : "+v"(tid));
    const int wid = __builtin_amdgcn_readfirstlane(tid >> 6), lane = tid & 63, wr = wid >> 2, wc = wid & 3, fr = lane & 15, fq = lane >> 4;
    int K_ = g.K, lda_ = g.lda; asm volatile("" : "+s"(K_), "+s"(lda_));
    const int K = K_, nt = K / BK, lda = lda_;
    unsigned voffA[2], voffB[2];
#pragma unroll
    for (int i = 0; i < 2; ++i) { int R, C; stage_rc(tid * 16 + i * 8192, R, C); const int Rb = Epi::PERM ? ((R & ~31) + perm32(R & 31)) : R;
        voffA[i] = (unsigned)(R * lda + C) * 2u; voffB[i] = (unsigned)(Rb * K + C) * 2u; }
    const size_t kstep = (size_t)(BK * 2);
    const size_t hstepA = (size_t)HALF * lda * 2, hstepB = (size_t)HALF * K * 2;
    const size_t tstepA = 2 * hstepA, tstepB = 2 * hstepB;
    const unsigned ldsw = (unsigned)wid * 1024u;
    const int aoff = lds_byte(wr * 64 + fr, fq * 8), boff = lds_byte(wc * 32 + fr, fq * 8);
#define PG8_SA(b, h) (((b) * 2 + (h)) * HTB)
#define PG8_SB(b, h) ((4 + (b) * 2 + (h)) * HTB)
#define PG8_STAGE(bufoff, gbase, voff) do { _Pragma("unroll") for (int _i = 0; _i < 2; ++_i) \
        __builtin_amdgcn_global_load_lds((const unsigned*)((const char*)(gbase) + (voff)[_i]), (PG8_LAS unsigned*)(lds + (bufoff) + ldsw + _i * 8192), 16, 0, 0); } while (0)
#define PG8_LDA(dst, b, h) do { _Pragma("unroll") for (int m = 0; m < 4; ++m) _Pragma("unroll") for (int k = 0; k < 2; ++k) dst[m][k] = *(const PG8_LAS bf16x8*)(lds + PG8_SA(b, h) + aoff + m * 2048 + k * 1024); } while (0)
#define PG8_LDB(dst, b, h) do { _Pragma("unroll") for (int n = 0; n < 2; ++n) _Pragma("unroll") for (int k = 0; k < 2; ++k) dst[n][k] = *(const PG8_LAS bf16x8*)(lds + PG8_SB(b, h) + boff + n * 2048 + k * 1024); } while (0)
#define PG8_MMA(ai, bj, At, Bt) do { __builtin_amdgcn_s_setprio(1); _Pragma("unroll") for (int m = 0; m < 4; ++m) _Pragma("unroll") for (int n = 0; n < 2; ++n) _Pragma("unroll") for (int k = 0; k < 2; ++k) \
        acc[ai][bj][m][n] = __builtin_amdgcn_mfma_f32_16x16x32_bf16(Bt[n][k], At[m][k], acc[ai][bj][m][n], 0, 0, 0); __builtin_amdgcn_s_setprio(0); } while (0)
#define PG8_WAIT_V(n) asm volatile("s_waitcnt vmcnt(" #n ")" ::: "memory")
#define PG8_WAIT_L(n) asm volatile("s_waitcnt lgkmcnt(" #n ")" ::: "memory")
#define PG8_BAR __builtin_amdgcn_s_barrier()
#define PG8_SCHED __builtin_amdgcn_sched_barrier(0)
    Unit cur, nxt; int ui = 0;
    if (!S.next(0, cur)) return;
    f32x4 acc[2][2][4][2];
#pragma unroll
    for (int a = 0; a < 2; ++a)
#pragma unroll
        for (int b = 0; b < 2; ++b)
#pragma unroll
            for (int m = 0; m < 4; ++m)
#pragma unroll
                for (int n = 0; n < 2; ++n) acc[a][b][m][n] = (f32x4){0.f, 0.f, 0.f, 0.f};
    bf16x8 At[4][2], B0[2][2], B1[2][2];
    const char* cA = (const char*)g.A + (size_t)cur.pm * tstepA; const char* cB = (const char*)g.Bt + (size_t)cur.pn * tstepB;
    PG8_STAGE(PG8_SB(0, 0), cB, voffB); PG8_STAGE(PG8_SB(0, 1), cB + hstepB, voffB); PG8_STAGE(PG8_SA(0, 0), cA, voffA); PG8_STAGE(PG8_SA(0, 1), cA + hstepA, voffA);
    if (wr == 1) PG8_BAR;
    PG8_WAIT_V(2); PG8_BAR;
    PG8_STAGE(PG8_SB(1, 0), cB + kstep, voffB); PG8_STAGE(PG8_SA(1, 0), cA + kstep, voffA); PG8_STAGE(PG8_SB(1, 1), cB + hstepB + kstep, voffB);
    PG8_WAIT_V(6); PG8_BAR;
    for (;;) {
        const bool has_next = S.next(ui + 1, nxt);
        const char* nA = has_next ? (const char*)g.A + (size_t)nxt.pm * tstepA : cA; const char* nB = has_next ? (const char*)g.Bt + (size_t)nxt.pn * tstepB : cB;
        for (int t = 0; t < nt; t += 2) {
            const bool last = (t == nt - 2);
            const char* a1 = cA + (size_t)(t + 1) * kstep;
            const char* a2 = last ? nA : cA + (size_t)(t + 2) * kstep; const char* b2 = last ? nB : cB + (size_t)(t + 2) * kstep;
            const char* a3 = a2 + kstep; const char* b3 = b2 + kstep;
            PG8_LDB(B0, 0, 0); PG8_LDB(B1, 0, 1); PG8_SCHED; PG8_LDA(At, 0, 0); PG8_STAGE(PG8_SA(1, 1), a1 + hstepA, voffA);
            PG8_WAIT_V(8); PG8_WAIT_L(0); PG8_BAR; PG8_MMA(0, 0, At, B0); PG8_MMA(0, 1, At, B1); PG8_BAR; PG8_SCHED;
            PG8_LDA(At, 0, 1); PG8_STAGE(PG8_SB(0, 0), b2, voffB); PG8_STAGE(PG8_SB(0, 1), b2 + hstepB, voffB); PG8_STAGE(PG8_SA(0, 0), a2, voffA);
            PG8_WAIT_V(8); PG8_WAIT_L(0); PG8_BAR; PG8_MMA(1, 0, At, B0); PG8_MMA(1, 1, At, B1); PG8_BAR; PG8_SCHED;
            PG8_LDB(B0, 1, 0); PG8_LDB(B1, 1, 1); PG8_SCHED; PG8_LDA(At, 1, 0); PG8_STAGE(PG8_SA(0, 1), a2 + hstepA, voffA);
            PG8_WAIT_V(8); PG8_WAIT_L(0); PG8_BAR; PG8_MMA(0, 0, At, B0); PG8_MMA(0, 1, At, B1); PG8_BAR; PG8_SCHED;
            PG8_LDA(At, 1, 1); PG8_STAGE(PG8_SB(1, 0), b3, voffB); PG8_STAGE(PG8_SB(1, 1), b3 + hstepB, voffB); PG8_STAGE(PG8_SA(1, 0), a3, voffA);
            PG8_WAIT_V(8); PG8_WAIT_L(0); PG8_BAR; PG8_MMA(1, 0, At, B0); PG8_MMA(1, 1, At, B1); PG8_BAR; PG8_SCHED;
        }
        if constexpr (ALIGN_EPI) { if (wr == 0) PG8_BAR; }
        E(acc, cur, wr, wc, fr, fq);
        if (!has_next) break;
#pragma unroll
        for (int a = 0; a < 2; ++a)
#pragma unroll
            for (int b = 0; b < 2; ++b)
#pragma unroll
                for (int m = 0; m < 4; ++m)
#pragma unroll
                    for (int n = 0; n < 2; ++n) acc[a][b][m][n] = (f32x4){0.f, 0.f, 0.f, 0.f};
        cur = nxt; cA = nA; cB = nB; ++ui;
        if constexpr (ALIGN_EPI) { if (wr == 1) PG8_BAR; }
    }
    PG8_WAIT_V(0);
    if constexpr (!ALIGN_EPI) { if (wr == 0) PG8_BAR; }
    PG8_BAR;
#undef PG8_SA
#undef PG8_SB
#undef PG8_STAGE
#undef PG8_LDA
#undef PG8_LDB
#undef PG8_MMA
#undef PG8_WAIT_V
#undef PG8_WAIT_L
#undef PG8_BAR
#undef PG8_SCHED
}
}

#define LAS __attribute__((address_space(3)))
typedef unsigned short bf16_t;
typedef short bf16x8 __attribute__((ext_vector_type(8)));
typedef short s16x4 __attribute__((ext_vector_type(4)));
typedef float f32x4 __attribute__((ext_vector_type(4)));
typedef float f32x16 __attribute__((ext_vector_type(16)));
typedef unsigned u32x4 __attribute__((ext_vector_type(4)));
typedef unsigned u32x2 __attribute__((ext_vector_type(2)));

constexpr int NB = 8, S = 4096, D = 1024, M = NB * S, DEPTH = 2;
constexpr int IN_W = 2080, HP = 2112, N_IN = 2304;
constexpr int DFF = 2816;
constexpr int HC_CQ = 0, HC_CKV = 256, HC_DQ = 384, HC_DK = 768, HC_DV = 1152, HC_GQ = 1536, HC_GK = 1792, HC_GV = 1920, HC_KR = 2048;
constexpr int K_UP = 384, N_UP = 1536, UP_Q = 0, UP_K = 576, UP_V = 960, UP_END = 1344;
constexpr int QAP = 576, KAP = 576, VAP = 384, CATP = 1024, OBP = 384;
constexpr float LOG2E = 1.4426950408889634f;
constexpr float C2_MLA = 0.10206207261596575f * LOG2E;
constexpr float C2_64 = 0.125f * LOG2E;
constexpr float DN_ALPHA = 1.4142135623730951f;
constexpr float NEG_BIG = -1e30f;

constexpr size_t MiB = 1u << 20;
constexpr size_t WS_CTL = 0;
constexpr size_t WS_TAB = 1 * MiB;
constexpr size_t WS_W = 2 * MiB;
constexpr size_t W_IN = 0, W_IN_B = (size_t)N_IN * 1024 * 2;
constexpr size_t W_UP = W_IN + W_IN_B, W_UP_B = (size_t)N_UP * K_UP * 2;
constexpr size_t W_OUT = W_UP + W_UP_B, W_OUT_B = (size_t)1024 * 1024 * 2;
constexpr size_t W_GU = W_OUT + W_OUT_B, W_GU_B = (size_t)2 * DFF * 1024 * 2;
constexpr size_t W_DN = W_GU + W_GU_B, W_DN_B = (size_t)1024 * DFF * 2;
constexpr size_t W_LAYER = ((W_DN + W_DN_B + 65535) / 65536) * 65536;
constexpr size_t WS_XB = 54 * MiB;
constexpr size_t WS_CAT = 118 * MiB;
constexpr size_t WS_OB = 182 * MiB;
constexpr size_t WS_LSE = 254 * MiB;
constexpr size_t WS_VA = 257 * MiB;
constexpr size_t WS_H = 281 * MiB;
constexpr size_t WS_QA = 413 * MiB;
constexpr size_t WS_KA = 449 * MiB;
constexpr size_t WS_END = 485 * MiB;
constexpr size_t WS_ACT = WS_H;
static_assert(WS_W + 2 * W_LAYER <= WS_XB, "weights fit");
static_assert(WS_ACT + (size_t)M * DFF * 2 <= WS_END, "act fits");

constexpr int LDS_BYTES = 147456;
constexpr int NWAVES = 8, NTHREADS = 512;

__device__ __forceinline__ float bf2f(unsigned short h) { return __builtin_bit_cast(float, (unsigned)h << 16); }
__device__ __forceinline__ unsigned pk2(float lo, float hi) { return pg8::cvt_pk_bf16(lo, hi); }
__device__ __forceinline__ float shx(float v, int o, int lane) { return __builtin_bit_cast(float, __builtin_amdgcn_ds_bpermute((lane ^ o) << 2, __builtin_bit_cast(int, v))); }
__device__ __forceinline__ float wave_sum(float v, int lane) {
#pragma unroll
    for (int o = 1; o < 64; o <<= 1) v += shx(v, o, lane);
    return v;
}

using pg8::Unit;
struct EpiH {
    static constexpr bool PERM = true;
    bf16_t* H;
    __device__ __forceinline__ void operator()(const f32x4 (&acc)[2][2][4][2], const Unit& u, int wr, int wc, int fr, int fq) const {
        const int row0 = u.pm * 256 + wr * 64 + fr;
#pragma unroll
        for (int bj = 0; bj < 2; ++bj) {
            const int col = u.pn * 256 + bj * 128 + wc * 32 + 8 * fq;
            if (col < IN_W) {
#pragma unroll
                for (int ai = 0; ai < 2; ++ai)
#pragma unroll
                    for (int m = 0; m < 4; ++m) {
                        const f32x4 v0 = acc[ai][bj][m][0], v1 = acc[ai][bj][m][1];
                        u32x4 w; w.x = pk2(v0[0], v0[1]); w.y = pk2(v0[2], v0[3]); w.z = pk2(v1[0], v1[1]); w.w = pk2(v1[2], v1[3]);
                        *(u32x4*)(H + (size_t)(row0 + ai * 128 + m * 16) * HP + col) = w;
                    }
            }
        }
    }
};
struct EpiUp {
    static constexpr bool PERM = true;
    bf16_t* QA; bf16_t* KA; bf16_t* VA;
    __device__ __forceinline__ void operator()(const f32x4 (&acc)[2][2][4][2], const Unit& u, int wr, int wc, int fr, int fq) const {
        const int row0 = u.pm * 256 + wr * 64 + fr;
#pragma unroll
        for (int bj = 0; bj < 2; ++bj) {
            const int colw = u.pn * 256 + bj * 128 + wc * 32;
            bf16_t* base; int pitch;
            if (colw < UP_K) { base = QA + colw; pitch = QAP; }
            else if (colw < UP_V) { const int c = colw - UP_K; base = KA + (c >> 6) * 96 + (c & 63); pitch = KAP; }
            else if (colw < UP_END) { base = VA + (colw - UP_V); pitch = VAP; }
            else continue;
            base += 8 * fq;
#pragma unroll
            for (int ai = 0; ai < 2; ++ai)
#pragma unroll
                for (int m = 0; m < 4; ++m) {
                    const f32x4 v0 = acc[ai][bj][m][0], v1 = acc[ai][bj][m][1];
                    u32x4 w; w.x = pk2(v0[0], v0[1]); w.y = pk2(v0[2], v0[3]); w.z = pk2(v1[0], v1[1]); w.w = pk2(v1[2], v1[3]);
                    *(u32x4*)(base + (size_t)(row0 + ai * 128 + m * 16) * pitch) = w;
                }
        }
    }
};
struct EpiRes {
    static constexpr bool PERM = false;
    const float* res; float* out;
    __device__ __forceinline__ void operator()(const f32x4 (&acc)[2][2][4][2], const Unit& u, int wr, int wc, int fr, int fq) const {
        const int row0 = u.pm * 256 + wr * 64 + fr, col0 = u.pn * 256 + wc * 32 + 4 * fq;
#pragma unroll
        for (int ai = 0; ai < 2; ++ai)
#pragma unroll
            for (int m = 0; m < 4; ++m) {
                const size_t off = (size_t)(row0 + ai * 128 + m * 16) * D + col0;
                f32x4 r[2][2];
#pragma unroll
                for (int bj = 0; bj < 2; ++bj)
#pragma unroll
                    for (int n = 0; n < 2; ++n) r[bj][n] = *(const f32x4*)(res + off + bj * 128 + n * 16);
#pragma unroll
                for (int bj = 0; bj < 2; ++bj)
#pragma unroll
                    for (int n = 0; n < 2; ++n) *(f32x4*)(out + off + bj * 128 + n * 16) = r[bj][n] * DN_ALPHA + acc[ai][bj][m][n];
                asm volatile("" ::: "memory");
            }
    }
};
struct EpiSwiglu {
    static constexpr bool PERM = true;
    bf16_t* ACT;
    __device__ __forceinline__ float f(float g, float u) const { return g * u * __builtin_amdgcn_rcpf(1.0f + __builtin_amdgcn_exp2f(-LOG2E * g)); }
    __device__ __forceinline__ void operator()(const f32x4 (&acc)[2][2][4][2], const Unit& u, int wr, int wc, int fr, int fq) const {
        const int row0 = u.pm * 256 + wr * 64 + fr, col = u.pn * 128 + wc * 32 + 8 * fq;
#pragma unroll
        for (int ai = 0; ai < 2; ++ai)
#pragma unroll
            for (int m = 0; m < 4; ++m) {
                const f32x4 g0 = acc[ai][0][m][0], g1 = acc[ai][0][m][1], u0 = acc[ai][1][m][0], u1 = acc[ai][1][m][1];
                u32x4 w; w.x = pk2(f(g0[0], u0[0]), f(g0[1], u0[1])); w.y = pk2(f(g0[2], u0[2]), f(g0[3], u0[3]));
                w.z = pk2(f(g1[0], u1[0]), f(g1[1], u1[1])); w.w = pk2(f(g1[2], u1[2]), f(g1[3], u1[3]));
                *(u32x4*)(ACT + (size_t)(row0 + ai * 128 + m * 16) * DFF + col) = w;
            }
    }
};

namespace att {
typedef LAS const char* lds_cptr;
typedef short v4i16_t __attribute__((ext_vector_type(4)));
__device__ __forceinline__ int crow(int r, int hi) { return (r & 3) + 8 * (r >> 2) + 4 * hi; }
__device__ __forceinline__ s16x4 vtr(lds_cptr p) { return __builtin_bit_cast(s16x4, __builtin_amdgcn_ds_read_tr16_b64_v4i16((LAS v4i16_t*)p)); }
__device__ __forceinline__ float swap_max(float m) { auto rr = __builtin_amdgcn_permlane32_swap(__float_as_uint(m), __float_as_uint(m), false, false); return fmaxf(__uint_as_float(rr[0]), __uint_as_float(rr[1])); }
__device__ __forceinline__ float swap_sum(float m) { auto rr = __builtin_amdgcn_permlane32_swap(__float_as_uint(m), __float_as_uint(m), false, false); return __uint_as_float(rr[0]) + __uint_as_float(rr[1]); }
__device__ __forceinline__ float rowmax(const f32x16& p0, const f32x16& p1) {
    float a = fmaxf(p0[0], p1[0]), b = fmaxf(p0[1], p1[1]);
#pragma unroll
    for (int r = 2; r < 16; r += 2) { a = fmaxf(a, fmaxf(p0[r], p1[r])); b = fmaxf(b, fmaxf(p0[r + 1], p1[r + 1])); }
    return swap_max(fmaxf(a, b));
}
template <int NQ> __device__ __forceinline__ void qkt(f32x16& p0, f32x16& p1, lds_cptr Kslot, const bf16x8* qr, int r32, int hi) {
    lds_cptr kb = Kslot + hi * 1024 + r32 * 16;
    p0 = (f32x16){}; p1 = (f32x16){};
#pragma unroll
    for (int d0 = 0; d0 < NQ; ++d0) {
        const bf16x8 b0 = *(const LAS bf16x8*)(kb + d0 * 2048);
        const bf16x8 b1 = *(const LAS bf16x8*)(kb + d0 * 2048 + 512);
        p0 = __builtin_amdgcn_mfma_f32_32x32x16_bf16(b0, qr[d0], p0, 0, 0, 0);
        p1 = __builtin_amdgcn_mfma_f32_32x32x16_bf16(b1, qr[d0], p1, 0, 0, 0);
    }
}
__device__ __forceinline__ void pv(f32x16* o, lds_cptr vp, const u32x4& pw0, const u32x4& pw1, const u32x4& pw2, const u32x4& pw3) {
#pragma unroll
    for (int d0 = 0; d0 < 2; ++d0) {
        s16x4 lo[4], hi[4];
#pragma unroll
        for (int ks = 0; ks < 4; ++ks) { lo[ks] = vtr(vp + d0 * 4096 + ks * 1024); hi[ks] = vtr(vp + d0 * 4096 + ks * 1024 + 512); }
#define PK(k) (bf16x8){lo[k][0], lo[k][1], lo[k][2], lo[k][3], hi[k][0], hi[k][1], hi[k][2], hi[k][3]}
        o[d0] = __builtin_amdgcn_mfma_f32_32x32x16_bf16(__builtin_bit_cast(bf16x8, pw0), PK(0), o[d0], 0, 0, 0);
        o[d0] = __builtin_amdgcn_mfma_f32_32x32x16_bf16(__builtin_bit_cast(bf16x8, pw1), PK(1), o[d0], 0, 0, 0);
        o[d0] = __builtin_amdgcn_mfma_f32_32x32x16_bf16(__builtin_bit_cast(bf16x8, pw2), PK(2), o[d0], 0, 0, 0);
        o[d0] = __builtin_amdgcn_mfma_f32_32x32x16_bf16(__builtin_bit_cast(bf16x8, pw3), PK(3), o[d0], 0, 0, 0);
#undef PK
    }
}
constexpr float THR = 8.0f;
__device__ __forceinline__ void softmax_pv(f32x16& p0, f32x16& p1, float& m, float& l, f32x16* o, lds_cptr vp, LAS float* wsf, int r32, int hi) {
    const float rm = rowmax(p0, p1);
    if (__any(rm > m + THR)) {
        const float mn = fmaxf(m, rm), f = __builtin_amdgcn_exp2f(m - mn);
        l *= f; m = mn;
        if (hi == 0) wsf[r32] = f;
        asm volatile("s_waitcnt lgkmcnt(0)" ::: "memory");
#pragma unroll
        for (int r = 0; r < 16; ++r) { const float fr_ = wsf[crow(r, hi)]; o[0][r] *= fr_; o[1][r] *= fr_; }
    }
    float s0 = 0.f, s1 = 0.f;
#pragma unroll
    for (int r = 0; r < 16; ++r) { p0[r] = __builtin_amdgcn_exp2f(p0[r] - m); p1[r] = __builtin_amdgcn_exp2f(p1[r] - m); s0 += p0[r]; s1 += p1[r]; }
    l += s0 + s1;
    u32x4 pw0, pw1, pw2, pw3;
    pw0 = (u32x4){pk2(p0[0], p0[1]), pk2(p0[2], p0[3]), pk2(p0[4], p0[5]), pk2(p0[6], p0[7])};
    pw1 = (u32x4){pk2(p0[8], p0[9]), pk2(p0[10], p0[11]), pk2(p0[12], p0[13]), pk2(p0[14], p0[15])};
    pw2 = (u32x4){pk2(p1[0], p1[1]), pk2(p1[2], p1[3]), pk2(p1[4], p1[5]), pk2(p1[6], p1[7])};
    pw3 = (u32x4){pk2(p1[8], p1[9]), pk2(p1[10], p1[11]), pk2(p1[12], p1[13]), pk2(p1[14], p1[15])};
    pv(o, vp, pw0, pw1, pw2, pw3);
}
template <class RowFn> __device__ __forceinline__ float finish(f32x16* o, float l, LAS float* wsf, LAS bf16_t* stg, bf16_t* O, int opitch, RowFn orow, int lane, int r32, int hi) {
    const float lt = swap_sum(l);
    if (hi == 0) wsf[32 + r32] = lt;
    asm volatile("s_waitcnt lgkmcnt(0)" ::: "memory");
#pragma unroll
    for (int r = 0; r < 16; ++r) {
        const int orw = crow(r, hi); const float rl = __builtin_amdgcn_rcpf(wsf[32 + orw]);
#pragma unroll
        for (int d0 = 0; d0 < 2; ++d0) stg[orw * 64 + d0 * 32 + r32] = (bf16_t)(pk2(o[d0][r] * rl, 0.f) & 0xffffu);
    }
    asm volatile("s_waitcnt lgkmcnt(0)" ::: "memory");
#pragma unroll
    for (int i = 0; i < 4; ++i) { const int row = i * 8 + (lane >> 3), ch = lane & 7; const u32x4 v = *(const LAS u32x4*)(stg + row * 64 + ch * 8); *(u32x4*)(O + (size_t)orow(row) * opitch + ch * 8) = v; }
    return lt;
}

constexpr int DL_K = 0, DL_V = 24576, DL_WS = 40960, DL_ST = 43008;
template <int DK, bool ROPE>
__device__ __forceinline__ void dense_unit(LAS unsigned char* lds, const bf16_t* Q, int qp, const bf16_t* K, int kp, const bf16_t* V, int vp_, bf16_t* O, int op,
                                           long rowbase, int q0, const float2* tab) {
    constexpr int NQ = DK / 16;
    int tid = threadIdx.x; asm volatile("" : "+v"(tid)); const int lane = tid & 63, r32 = lane & 31, hi = lane >> 5; const int wid = __builtin_amdgcn_readfirstlane(tid >> 6);
    LAS float* wsf = (LAS float*)(lds + DL_WS) + wid * 64;
    LAS bf16_t* stg = (LAS bf16_t*)(lds + DL_ST) + wid * 2048;
    bf16x8 qr[NQ];
    { const bf16_t* qrow = Q + (size_t)(rowbase + q0 + wid * 32 + r32) * qp + hi * 8;
#pragma unroll
      for (int d0 = 0; d0 < NQ; ++d0) qr[d0] = *(const bf16x8*)(qrow + d0 * 16);
      if (ROPE) {
          const float2* t = tab + (size_t)(q0 + wid * 32 + r32) * 16 + 8 * hi;
          bf16x8 a = qr[NQ - 2], b = qr[NQ - 1];
#pragma unroll
          for (int j = 0; j < 8; j += 2) {
              const float2 c0 = t[j], c1 = t[j + 1];
              const float x10 = bf2f((unsigned short)a[j]), x20 = bf2f((unsigned short)b[j]), x11 = bf2f((unsigned short)a[j + 1]), x21 = bf2f((unsigned short)b[j + 1]);
              const unsigned wa = pk2(x10 * c0.x - x20 * c0.y, x11 * c1.x - x21 * c1.y), wb = pk2(x10 * c0.y + x20 * c0.x, x11 * c1.y + x21 * c1.x);
              a[j] = (short)(wa & 0xffff); a[j + 1] = (short)(wa >> 16); b[j] = (short)(wb & 0xffff); b[j + 1] = (short)(wb >> 16);
          }
          qr[NQ - 2] = a; qr[NQ - 1] = b;
      } }
    const bf16_t* ksrc = K + (size_t)(rowbase + lane) * kp + wid * 8;
    const bf16_t* vsrc = V + (size_t)(rowbase + 16 * (wid & 3) + (lane >> 2)) * vp_ + (wid >> 2) * 32 + (lane & 3) * 8;
    const int kdst = DL_K + wid * 1024 + lane * 16, vdst = DL_V + wid * 1024 + lane * 16;
    const bool k2 = (DK == 96) && (wid < 4);
    u32x4 kr0, kr1 = (u32x4){}, vr;
    kr0 = *(const u32x4*)ksrc; if (k2) kr1 = *(const u32x4*)(ksrc + 64); vr = *(const u32x4*)vsrc;
    *(LAS u32x4*)(lds + kdst) = kr0; if (k2) *(LAS u32x4*)(lds + kdst + 8192) = kr1; *(LAS u32x4*)(lds + vdst) = vr;
    __syncthreads();
    float m = NEG_BIG, l = 0.f; f32x16 o[2]; o[0] = (f32x16){}; o[1] = (f32x16){};
    const int vrd = ((lane >> 4) & 1) * 32 + (lane & 3) * 8 + (4 * hi + ((lane & 15) >> 2)) * 64;
    constexpr int NT = S / 64;
    for (int t = 0; t < NT; ++t) {
        const int cur = t & 1, nx = cur ^ 1;
        if (t + 1 < NT) { const size_t ko = (size_t)(t + 1) * 64 * kp, vo = (size_t)(t + 1) * 64 * vp_;
            kr0 = *(const u32x4*)(ksrc + ko); if (k2) kr1 = *(const u32x4*)(ksrc + ko + 64); vr = *(const u32x4*)(vsrc + vo); }
        f32x16 p0, p1;
        qkt<NQ>(p0, p1, (lds_cptr)(lds + DL_K + cur * 12288), qr, r32, hi);
        softmax_pv(p0, p1, m, l, o, (lds_cptr)(lds + DL_V + cur * 8192 + vrd), wsf, r32, hi);
        if (t + 1 < NT) { *(LAS u32x4*)(lds + kdst + nx * 12288) = kr0; if (k2) *(LAS u32x4*)(lds + kdst + nx * 12288 + 8192) = kr1; *(LAS u32x4*)(lds + vdst + nx * 8192) = vr; }
        __syncthreads();
    }
    const long orow0 = rowbase + q0 + wid * 32;
    finish(o, l, wsf, stg, O, op, [&](int i) { return orow0 + i; }, lane, r32, hi);
    __syncthreads();
}

constexpr int XL_T = 0, XL_LUT = 98304, XL_WS = 99328, XL_ST = 101376;
__device__ __forceinline__ int t5_bucket_abs(int n) {
    return n < 8 ? n : 8 + (n >= 15) + (n >= 27) + (n >= 50) + (n >= 91) + (n >= 166) + (n >= 305) + (n >= 559);
}
__device__ __forceinline__ void dil_unit(LAS unsigned char* lds, const bf16_t* H, bf16_t* OB, float* LSE, const float* rel_bias, int b, int h, int br, int c, int j) {
    int tid = threadIdx.x; asm volatile("" : "+v"(tid)); const int lane = tid & 63, r32 = lane & 31, hi = lane >> 5; const int wid = __builtin_amdgcn_readfirstlane(tid >> 6);
    const int dsh = 2 * br, dil = 1 << dsh, L = S >> dsh, nb = L >> 6;
    LAS float* lut = (LAS float*)(lds + XL_LUT);
    LAS float* wsf = (LAS float*)(lds + XL_WS) + wid * 64;
    LAS bf16_t* stg = (LAS bf16_t*)(lds + XL_ST) + wid * 2048;
    if (tid < 256) { const int rel = tid - 127, n = rel < 0 ? -rel : rel; const int bk = (rel > 0 ? 16 : 0) + t5_bucket_abs(n * dil);
        lut[tid] = (n <= 64 && tid < 255) ? rel_bias[bk * 6 + h] * LOG2E : NEG_BIG; }
    const long rowb = (long)b * S;
    { u32x4 kr[6], vr[6];
#pragma unroll
      for (int s = 0; s < 6; ++s) { const int kt = 4 * j - 1 + s;
          if (kt >= 0 && kt < nb) {
              const long krow = rowb + (((long)(64 * kt + lane)) << dsh) + c, vrow = rowb + (((long)(64 * kt + 16 * (wid & 3) + (lane >> 2))) << dsh) + c;
              kr[s] = *(const u32x4*)(H + (size_t)krow * HP + HC_DK + h * 64 + wid * 8);
              vr[s] = *(const u32x4*)(H + (size_t)vrow * HP + HC_DV + h * 64 + (wid >> 2) * 32 + (lane & 3) * 8);
          } else { kr[s] = (u32x4){}; vr[s] = (u32x4){}; } }
#pragma unroll
      for (int s = 0; s < 6; ++s) { *(LAS u32x4*)(lds + XL_T + s * 16384 + wid * 1024 + lane * 16) = kr[s]; *(LAS u32x4*)(lds + XL_T + s * 16384 + 8192 + wid * 1024 + lane * 16) = vr[s]; } }
    const int n = 4 * j + (wid >> 1), lq0 = 64 * n + 32 * (wid & 1);
    bf16x8 qr[4];
    { const long qrow = rowb + (((long)(lq0 + r32)) << dsh) + c; const bf16_t* qp = H + (size_t)qrow * HP + HC_DQ + h * 64 + hi * 8;
#pragma unroll
      for (int d0 = 0; d0 < 4; ++d0) qr[d0] = *(const bf16x8*)(qp + d0 * 16); }
    __syncthreads();
    float m = NEG_BIG, l = 0.f; f32x16 o[2]; o[0] = (f32x16){}; o[1] = (f32x16){};
    const int vrd = ((lane >> 4) & 1) * 32 + (lane & 3) * 8 + (4 * hi + ((lane & 15) >> 2)) * 64;
#pragma unroll 1
    for (int dt = -1; dt <= 1; ++dt) {
        const int kt = n + dt; if (kt < 0 || kt >= nb) continue;
        const int slot = (wid >> 1) + dt + 1;
        f32x16 p0, p1;
        qkt<4>(p0, p1, (lds_cptr)(lds + XL_T + slot * 16384), qr, r32, hi);
        const int ib = 64 * dt - 32 * (wid & 1) - r32 + 127 + 4 * hi;
#pragma unroll
        for (int r = 0; r < 16; ++r) { const int kv = (r & 3) + 8 * (r >> 2); p0[r] += lut[ib + kv]; p1[r] += lut[ib + kv + 32]; }
        softmax_pv(p0, p1, m, l, o, (lds_cptr)(lds + XL_T + slot * 16384 + 8192 + vrd), wsf, r32, hi);
    }
    const long tok0 = rowb + (((long)lq0) << dsh) + c;
    const float lt = finish(o, l, wsf, stg, OB + h * 64, OBP, [&](int i) { return tok0 + ((long)i << dsh); }, lane, r32, hi);
    if (hi == 0) LSE[(size_t)(tok0 + ((long)r32 << dsh)) * 6 + h] = m + __builtin_amdgcn_logf(lt);
    __syncthreads();
}
}

struct Args {
    const float* x; const float* w_in; const float* mla_q_norm; const float* mla_kv_norm; const float* w_uq; const float* w_ukv;
    const float* gqa_q_norm; const float* gqa_k_norm; const float* rel_bias; const float* w_out; const float* ln1_g; const float* ln1_b;
    const float* w_gate; const float* w_up; const float* w_down; const float* ln2_g; const float* ln2_b;
    float* out; unsigned char* ws; int ph_lo, ph_hi;
};

typedef const __attribute__((address_space(4))) Args* ArgsP;
__device__ __forceinline__ ArgsP opaque_args() { ArgsP p = (ArgsP)__builtin_amdgcn_kernarg_segment_ptr(); asm volatile("" : "+s"(p)); return p; }
__device__ __forceinline__ void transpose_item(const float* W, int N, int k0, int n0, bf16_t* WT, int drow0, int dpitch, int dk0, float scale, LAS float* scr, int lane) {
#pragma unroll 8
    for (int i = 0; i < 32; ++i) { const int kk = 2 * i + (lane >> 5); scr[kk * 33 + (lane & 31)] = W[(size_t)(k0 + kk) * N + n0 + (lane & 31)] * scale; }
    asm volatile("s_waitcnt lgkmcnt(0)" ::: "memory");
    const int c = lane & 7;
#pragma unroll
    for (int j = 0; j < 4; ++j) { const int n = (lane >> 3) + 8 * j; const LAS float* s = scr + (8 * c) * 33 + n;
        u32x4 o; o.x = pk2(s[0 * 33], s[1 * 33]); o.y = pk2(s[2 * 33], s[3 * 33]); o.z = pk2(s[4 * 33], s[5 * 33]); o.w = pk2(s[6 * 33], s[7 * 33]);
        *(u32x4*)(WT + (size_t)(drow0 + n) * dpitch + dk0 + k0 + 8 * c) = o; }
    asm volatile("s_waitcnt lgkmcnt(0)" ::: "memory");
}
__device__ __forceinline__ int inproj_map(int n0, float& scale) {
    scale = 1.f;
    if (n0 < 384) return n0;
    if (n0 < 416) return HC_KR + (n0 - 384);
    if (n0 < 800) { scale = C2_64; return HC_DQ + (n0 - 416); }
    if (n0 < 1184) return HC_DK + (n0 - 800);
    if (n0 < 1568) return HC_DV + (n0 - 1184);
    if (n0 < 1824) return HC_GQ + (n0 - 1568);
    if (n0 < 1952) return HC_GK + (n0 - 1824);
    return HC_GV + (n0 - 1952);
}
__device__ __forceinline__ void prologue(const __attribute__((address_space(4))) Args& a, LAS unsigned char* lds, int vcu, int G) {
    int tid = threadIdx.x; asm volatile("" : "+v"(tid)); const int lane = tid & 63, wave = __builtin_amdgcn_readfirstlane(tid >> 6);
    LAS float* scr = (LAS float*)(lds + wave * 16384);
    const int gw = vcu * NWAVES + wave, NGW = G * NWAVES;
    constexpr int I_IN = 16 * 65, I_UQ = 4 * 18, I_UKV = 2 * 24, I_OUT = 16 * 32, I_G = 16 * 88, I_U = 16 * 88, I_D = 44 * 32;
    constexpr int I_LAYER = I_IN + I_UQ + I_UKV + I_OUT + I_G + I_U + I_D;
    for (int it = gw; it < DEPTH * I_LAYER; it += NGW) {
        const int l = it / I_LAYER; int r = it % I_LAYER;
        unsigned char* wl = a.ws + WS_W + (size_t)l * W_LAYER;
        if (r < I_IN) { const int kb = r / 65, nb = r % 65; float sc; const int dr = inproj_map(32 * nb, sc);
            transpose_item(a.w_in + (size_t)l * 1024 * IN_W, IN_W, 64 * kb, 32 * nb, (bf16_t*)(wl + W_IN), dr, 1024, 0, sc, scr, lane); continue; } r -= I_IN;
        if (r < I_UQ) { const int kb = r / 18, nb = r % 18;
            transpose_item(a.w_uq + (size_t)l * 256 * 576, 576, 64 * kb, 32 * nb, (bf16_t*)(wl + W_UP), UP_Q + 32 * nb, K_UP, 0, C2_MLA, scr, lane); continue; } r -= I_UQ;
        if (r < I_UKV) { const int kb = r / 24, nb = r % 24; const int n0 = 32 * nb, hh = n0 >> 7, w = n0 & 127;
            const int dr = (w < 64) ? UP_K + hh * 64 + w : UP_V + hh * 64 + (w - 64);
            transpose_item(a.w_ukv + (size_t)l * 128 * 768, 768, 64 * kb, n0, (bf16_t*)(wl + W_UP), dr, K_UP, 256, 1.f, scr, lane); continue; } r -= I_UKV;
        if (r < I_OUT) { const int kb = r / 32, nb = r % 32;
            transpose_item(a.w_out + (size_t)l * 1024 * 1024, 1024, 64 * kb, 32 * nb, (bf16_t*)(wl + W_OUT), 32 * nb, 1024, 0, 1.f, scr, lane); continue; } r -= I_OUT;
        if (r < I_G) { const int kb = r / 88, nb = r % 88; const int n0 = 32 * nb;
            transpose_item(a.w_gate + (size_t)l * 1024 * DFF, DFF, 64 * kb, n0, (bf16_t*)(wl + W_GU), (n0 >> 7) * 256 + (n0 & 127), 1024, 0, 1.f, scr, lane); continue; } r -= I_G;
        if (r < I_U) { const int kb = r / 88, nb = r % 88; const int n0 = 32 * nb;
            transpose_item(a.w_up + (size_t)l * 1024 * DFF, DFF, 64 * kb, n0, (bf16_t*)(wl + W_GU), (n0 >> 7) * 256 + 128 + (n0 & 127), 1024, 0, 1.f, scr, lane); continue; } r -= I_U;
        { const int kb = r / 32, nb = r % 32;
            transpose_item(a.w_down + (size_t)l * DFF * 1024, 1024, 64 * kb, 32 * nb, (bf16_t*)(wl + W_DN), 32 * nb, DFF, 0, 1.f, scr, lane); }
    }
    const int gt = vcu * NTHREADS + tid, NGT = G * NTHREADS;
    for (int l = 0; l < DEPTH; ++l) {
        bf16_t* wu = (bf16_t*)(a.ws + WS_W + (size_t)l * W_LAYER + W_UP);
        for (int i = gt; i < 576 * 16; i += NGT) { const int row = i >> 4, ch = i & 15; *(u32x4*)(wu + (size_t)row * K_UP + 256 + ch * 8) = (u32x4){0u, 0u, 0u, 0u}; }
        for (int i = gt; i < 768 * 32; i += NGT) { const int row = 576 + (i >> 5), ch = i & 31; *(u32x4*)(wu + (size_t)row * K_UP + ch * 8) = (u32x4){0u, 0u, 0u, 0u}; }
    }
    float2* tab = (float2*)(a.ws + WS_TAB);
    for (int i = gt; i < 4096 * 16; i += NGT) { const int pos = i >> 4, f = i & 15; const float inv = exp2f(-(float)f * (13.287712379549449f / 16.0f));
        const float ang = (float)pos * inv; float sn, cs; sincosf(ang, &sn, &cs); tab[i] = make_float2(cs, sn); }
    bf16_t* xb = (bf16_t*)(a.ws + WS_XB);
    for (int i = gt; i < M * D / 8; i += NGT) { const f32x4 v0 = ((const f32x4*)a.x)[2 * (size_t)i], v1 = ((const f32x4*)a.x)[2 * (size_t)i + 1];
        u32x4 w; w.x = pk2(v0[0], v0[1]); w.y = pk2(v0[2], v0[3]); w.z = pk2(v1[0], v1[1]); w.w = pk2(v1[2], v1[3]); ((u32x4*)xb)[i] = w; }
}

__device__ __forceinline__ void prep_phase(const __attribute__((address_space(4))) Args& a, int l, int vcu, int G) {
    int tid = threadIdx.x; asm volatile("" : "+v"(tid)); const int lane = tid & 63, wave = tid >> 6;
    const int gw = vcu * NWAVES + wave, NGW = G * NWAVES;
    bf16_t* H = (bf16_t*)(a.ws + WS_H); bf16_t* KA = (bf16_t*)(a.ws + WS_KA);
    const float2* tab = (const float2*)(a.ws + WS_TAB);
    const float* gq = a.gqa_q_norm + l * 64; const float* gk = a.gqa_k_norm + l * 64;
    const float* nq = a.mla_q_norm + l * 256; const float* nkv = a.mla_kv_norm + l * 128;
    const int a16 = lane & 15, half = a16 >> 3, i0 = (a16 & 7) * 2, hd = lane >> 4;
    for (int tok = gw; tok < M; tok += NGW) {
        bf16_t* hrow = H + (size_t)tok * HP; const int s = tok & (S - 1);
        const int pos = half == 0 ? (s >> 6) : (s & 63);
        const float2 c0 = tab[pos * 16 + i0], c1 = tab[pos * 16 + i0 + 1];
        {
            bf16_t* p = hrow + HC_GQ + hd * 64 + half * 32 + i0;
            const unsigned w1 = *(const unsigned*)p, w2 = *(const unsigned*)(p + 16);
            float x10 = bf2f(w1 & 0xffff), x11 = bf2f(w1 >> 16), x20 = bf2f(w2 & 0xffff), x21 = bf2f(w2 >> 16);
            float ss = x10 * x10 + x11 * x11 + x20 * x20 + x21 * x21;
            ss += shx(ss, 1, lane); ss += shx(ss, 2, lane); ss += shx(ss, 4, lane); ss += shx(ss, 8, lane);
            const float rs = rsqrtf(ss * (1.0f / 64.0f) + 1e-6f);
            const int d = half * 32 + i0;
            x10 *= rs * gq[d]; x11 *= rs * gq[d + 1]; x20 *= rs * gq[d + 16]; x21 *= rs * gq[d + 17];
            const float o10 = (x10 * c0.x - x20 * c0.y) * C2_64, o11 = (x11 * c1.x - x21 * c1.y) * C2_64, o20 = (x10 * c0.y + x20 * c0.x) * C2_64, o21 = (x11 * c1.y + x21 * c1.x) * C2_64;
            *(unsigned*)p = pk2(o10, o11); *(unsigned*)(p + 16) = pk2(o20, o21);
        }
        {
            const bool isk = lane < 32, iskr = (lane >= 32 && lane < 40);
            const int ia = (lane & 7) * 2;
            bf16_t* p = isk ? hrow + HC_GK + hd * 64 + half * 32 + i0 : hrow + HC_KR + ia;
            unsigned w1 = 0, w2 = 0;
            if (isk || iskr) { w1 = *(const unsigned*)p; w2 = *(const unsigned*)(p + 16); }
            float x10 = bf2f(w1 & 0xffff), x11 = bf2f(w1 >> 16), x20 = bf2f(w2 & 0xffff), x21 = bf2f(w2 >> 16);
            float ss = x10 * x10 + x11 * x11 + x20 * x20 + x21 * x21;
            ss += shx(ss, 1, lane); ss += shx(ss, 2, lane); ss += shx(ss, 4, lane); ss += shx(ss, 8, lane);
            if (isk) {
                const float rs = rsqrtf(ss * (1.0f / 64.0f) + 1e-6f);
                const int d = half * 32 + i0;
                x10 *= rs * gk[d]; x11 *= rs * gk[d + 1]; x20 *= rs * gk[d + 16]; x21 *= rs * gk[d + 17];
                *(unsigned*)p = pk2(x10 * c0.x - x20 * c0.y, x11 * c1.x - x21 * c1.y); *(unsigned*)(p + 16) = pk2(x10 * c0.y + x20 * c0.x, x11 * c1.y + x21 * c1.x);
            } else if (iskr) {
                const float2 k0 = tab[s * 16 + ia], k1 = tab[s * 16 + ia + 1];
                const unsigned o1 = pk2(x10 * k0.x - x20 * k0.y, x11 * k1.x - x21 * k1.y), o2 = pk2(x10 * k0.y + x20 * k0.x, x11 * k1.y + x21 * k1.x);
                bf16_t* kd = KA + (size_t)tok * KAP + 64 + ia;
#pragma unroll
                for (int hh = 0; hh < 6; ++hh) { *(unsigned*)(kd + hh * 96) = o1; *(unsigned*)(kd + hh * 96 + 16) = o2; }
            }
        }
        {
            u32x2 w = *(const u32x2*)(hrow + HC_CQ + 4 * lane);
            float x0 = bf2f(w.x & 0xffff), x1 = bf2f(w.x >> 16), x2 = bf2f(w.y & 0xffff), x3 = bf2f(w.y >> 16);
            const float ss = wave_sum(x0 * x0 + x1 * x1 + x2 * x2 + x3 * x3, lane);
            const float rs = rsqrtf(ss * (1.0f / 256.0f) + 1e-6f);
            const f32x4 g = *(const f32x4*)(nq + 4 * lane);
            w.x = pk2(x0 * rs * g[0], x1 * rs * g[1]); w.y = pk2(x2 * rs * g[2], x3 * rs * g[3]);
            *(u32x2*)(hrow + HC_CQ + 4 * lane) = w;
        }
        {
            unsigned w = *(const unsigned*)(hrow + HC_CKV + 2 * lane);
            float x0 = bf2f(w & 0xffff), x1 = bf2f(w >> 16);
            const float ss = wave_sum(x0 * x0 + x1 * x1, lane);
            const float rs = rsqrtf(ss * (1.0f / 128.0f) + 1e-6f);
            *(unsigned*)(hrow + HC_CKV + 2 * lane) = pk2(x0 * rs * nkv[2 * lane], x1 * rs * nkv[2 * lane + 1]);
        }
    }
}

__device__ __forceinline__ void combine_phase(const __attribute__((address_space(4))) Args& a, int vcu, int G) {
    int tid = threadIdx.x; asm volatile("" : "+v"(tid)); const int gt = vcu * NTHREADS + tid, NGT = G * NTHREADS;
    const bf16_t* OB = (const bf16_t*)(a.ws + WS_OB); const float* LSE = (const float*)(a.ws + WS_LSE); bf16_t* CAT = (bf16_t*)(a.ws + WS_CAT);
    for (int i = gt; i < M * 48; i += NGT) {
        const int tok = i / 48, r = i % 48, h = r >> 3, ch = r & 7;
        float ls[3], w[3]; float mx = NEG_BIG;
#pragma unroll
        for (int b = 0; b < 3; ++b) { ls[b] = LSE[((size_t)b * M + tok) * 6 + h]; mx = fmaxf(mx, ls[b]); }
        float sum = 0.f;
#pragma unroll
        for (int b = 0; b < 3; ++b) { w[b] = __builtin_amdgcn_exp2f(ls[b] - mx); sum += w[b]; }
        const float inv = 1.0f / sum;
        float acc[8] = {0.f, 0.f, 0.f, 0.f, 0.f, 0.f, 0.f, 0.f};
#pragma unroll
        for (int b = 0; b < 3; ++b) { const u32x4 v = *(const u32x4*)(OB + ((size_t)b * M + tok) * OBP + h * 64 + ch * 8); const float wb = w[b] * inv;
#pragma unroll
            for (int k = 0; k < 4; ++k) { acc[2 * k] += wb * bf2f(v[k] & 0xffff); acc[2 * k + 1] += wb * bf2f(v[k] >> 16); } }
        u32x4 o; o.x = pk2(acc[0], acc[1]); o.y = pk2(acc[2], acc[3]); o.z = pk2(acc[4], acc[5]); o.w = pk2(acc[6], acc[7]);
        *(u32x4*)(CAT + (size_t)tok * CATP + 384 + h * 64 + ch * 8) = o;
    }
}

__device__ __forceinline__ void ln_phase(float* xf, bf16_t* xb, const float* g, const float* b, int vcu, int G) {
    int tid = threadIdx.x; asm volatile("" : "+v"(tid)); const int lane = tid & 63, wave = tid >> 6;
    const int gw = vcu * NWAVES + wave, NGW = G * NWAVES;
    f32x4 gv[4], bv[4];
#pragma unroll
    for (int j = 0; j < 4; ++j) { gv[j] = ((const f32x4*)g)[64 * j + lane]; bv[j] = ((const f32x4*)b)[64 * j + lane]; }
    for (int row = gw; row < M; row += NGW) {
        f32x4* xr = (f32x4*)(xf + (size_t)row * D) + lane;
        f32x4 v[4]; float s = 0.f;
#pragma unroll
        for (int j = 0; j < 4; ++j) { v[j] = xr[64 * j]; s += (v[j][0] + v[j][1]) + (v[j][2] + v[j][3]); }
        const float mean = wave_sum(s, lane) * (1.f / D); float s2 = 0.f;
#pragma unroll
        for (int j = 0; j < 4; ++j) { v[j] = v[j] - mean; s2 += (v[j][0] * v[j][0] + v[j][1] * v[j][1]) + (v[j][2] * v[j][2] + v[j][3] * v[j][3]); }
        const float rstd = rsqrtf(wave_sum(s2, lane) * (1.f / D) + 1e-5f);
        u32x2* o8 = (u32x2*)(xb + (size_t)row * D) + lane;
#pragma unroll
        for (int j = 0; j < 4; ++j) { const f32x4 y = v[j] * rstd * gv[j] + bv[j]; xr[64 * j] = y; o8[64 * j] = (u32x2){pk2(y[0], y[1]), pk2(y[2], y[3])}; }
    }
}

__device__ __forceinline__ void attn_phase(const __attribute__((address_space(4))) Args& a, LAS unsigned char* lds, int vcu, int G) {
    bf16_t* H = (bf16_t*)(a.ws + WS_H); bf16_t* QA = (bf16_t*)(a.ws + WS_QA); bf16_t* KA = (bf16_t*)(a.ws + WS_KA); bf16_t* VA = (bf16_t*)(a.ws + WS_VA);
    bf16_t* CAT = (bf16_t*)(a.ws + WS_CAT); bf16_t* OB = (bf16_t*)(a.ws + WS_OB); float* LSE = (float*)(a.ws + WS_LSE);
    const float2* tab = (const float2*)(a.ws + WS_TAB);
    for (int u = vcu; u < NB * 6 * 16; u += G) { const int bh = u >> 4, qb = u & 15, b = bh / 6, h = bh % 6;
        att::dense_unit<96, true>(lds, QA + h * 96, QAP, KA + h * 96, KAP, VA + h * 64, VAP, CAT + h * 64, CATP, (long)b * S, qb * 256, tab); }
    for (int u = vcu; u < NB * 4 * 16; u += G) { const int bh = u >> 4, qb = u & 15, b = bh >> 2, h = bh & 3, kvh = h >> 1;
        att::dense_unit<64, false>(lds, H + HC_GQ + h * 64, HP, H + HC_GK + kvh * 64, HP, H + HC_GV + kvh * 64, HP, CAT + 768 + h * 64, CATP, (long)b * S, qb * 256, tab); }
    for (int u = vcu; u < 3 * NB * 6 * 16; u += G) { const int br = u / 768, rem = u % 768, bh = rem >> 4, k = rem & 15, b = bh / 6, h = bh % 6; const int dil = 1 << (2 * br);
        att::dil_unit(lds, H, OB + (size_t)br * M * OBP, LSE + (size_t)br * M * 6, a.rel_bias, b, h, br, k & (dil - 1), k >> (2 * br)); }
}

#ifndef MK_MASK
#define MK_MASK 0x7ff
#endif
#define PH_ON(i) ((MK_MASK >> (i)) & 1)
constexpr int PH_PER_LAYER = 10, N_PHASES = 1 + DEPTH * PH_PER_LAYER;
__global__ void __launch_bounds__(NTHREADS, 2) mk_fwd(Args a_in) {
    extern __shared__ __attribute__((aligned(16))) unsigned char lds_raw[];
    LAS unsigned char* lds = (LAS unsigned char*)lds_raw;
    cg::grid_group grid = cg::this_grid();
    const int G = gridDim.x; const int bx = blockIdx.x; const int vcu = (G % 8 == 0) ? (bx % 8) * (G / 8) + bx / 8 : bx;
    const int ph_lo = a_in.ph_lo, ph_hi = a_in.ph_hi;
    for (int ph = ph_lo; ph < ph_hi; ++ph) {
        if (ph > ph_lo) grid.sync();
        const ArgsP ap = opaque_args();
        if (ph == 0) { if (PH_ON(10)) prologue(*ap, lds, vcu, G); continue; }
        const int l = (ph - 1) / PH_PER_LAYER, sp = (ph - 1) % PH_PER_LAYER;
        unsigned char* const ws = ap->ws;
        unsigned char* wl = ws + WS_W + (size_t)l * W_LAYER;
        float* XF = ap->out;
        bf16_t* XB = (bf16_t*)(ws + WS_XB);
        switch (sp) {
        case 0: if (PH_ON(0)) { pg8::Gemm g{XB, (const bf16_t*)(wl + W_IN), M, N_IN, 1024, 1024}; pg8::StaticOrder so; so.init(M, N_IN, G, bx);
                  EpiH E{(bf16_t*)(ws + WS_H)}; pg8::gemm_phase<EpiH, pg8::StaticOrder, true>(lds, g, so, E); } break;
        case 1: if (PH_ON(1)) prep_phase(*ap, l, vcu, G); break;
        case 2: if (PH_ON(2)) { pg8::Gemm g{(const bf16_t*)(ws + WS_H), (const bf16_t*)(wl + W_UP), M, N_UP, K_UP, HP}; pg8::StaticOrder so; so.init(M, N_UP, G, bx);
                  EpiUp E{(bf16_t*)(ws + WS_QA), (bf16_t*)(ws + WS_KA), (bf16_t*)(ws + WS_VA)}; pg8::gemm_phase<EpiUp, pg8::StaticOrder, true>(lds, g, so, E); } break;
        case 3: if (PH_ON(3)) attn_phase(*ap, lds, vcu, G); break;
        case 4: if (PH_ON(4)) combine_phase(*ap, vcu, G); break;
        case 5: if (PH_ON(5)) { pg8::Gemm g{(const bf16_t*)(ws + WS_CAT), (const bf16_t*)(wl + W_OUT), M, D, 1024, 1024}; pg8::StaticOrder so; so.init(M, D, G, bx);
                  EpiRes E{l == 0 ? ap->x : (const float*)XF, XF}; pg8::gemm_phase<EpiRes, pg8::StaticOrder, true>(lds, g, so, E); } break;
        case 6: if (PH_ON(6)) ln_phase(XF, XB, ap->ln1_g + l * D, ap->ln1_b + l * D, vcu, G); break;
        case 7: if (PH_ON(7)) { pg8::Gemm g{XB, (const bf16_t*)(wl + W_GU), M, 2 * DFF, 1024, 1024}; pg8::StaticOrder so; so.init(M, 2 * DFF, G, bx);
                  EpiSwiglu E{(bf16_t*)(ws + WS_ACT)}; pg8::gemm_phase<EpiSwiglu, pg8::StaticOrder, true>(lds, g, so, E); } break;
        case 8: if (PH_ON(8)) { pg8::Gemm g{(const bf16_t*)(ws + WS_ACT), (const bf16_t*)(wl + W_DN), M, D, DFF, DFF}; pg8::StaticOrder so; so.init(M, D, G, bx);
                  EpiRes E{(const float*)XF, XF}; pg8::gemm_phase<EpiRes, pg8::StaticOrder, true>(lds, g, so, E); } break;
        case 9: if (PH_ON(9)) ln_phase(XF, XB, ap->ln2_g + l * D, ap->ln2_b + l * D, vcu, G); break;
        }
    }
}

#ifndef MK_MULTI
#define MK_MULTI 1
#endif
extern "C" void kernel_launch(void* const* d_in, const int* in_sizes, int n_in, void* d_out, int out_size, void* d_ws, size_t ws_size, hipStream_t stream) {
    static int grid = 0;
    if (grid == 0) {
        if (n_in != 17 || in_sizes[0] != M * D || out_size != M * D || ws_size < WS_END) { fprintf(stderr, "kernel_launch: unexpected shapes (n_in %d, in0 %d, out %d, ws %zu < %zu)\n", n_in, n_in > 0 ? in_sizes[0] : -1, out_size, ws_size, (size_t)WS_END); grid = -1; return; }
        int dev = 0, cus = 0, per_cu = 0;
        hipGetDevice(&dev); hipDeviceGetAttribute(&cus, hipDeviceAttributeMultiprocessorCount, dev);
        if (hipFuncSetAttribute((const void*)mk_fwd, hipFuncAttributeMaxDynamicSharedMemorySize, LDS_BYTES) != hipSuccess) { fprintf(stderr, "kernel_launch: hipFuncSetAttribute failed\n"); grid = -1; return; }
        if (hipOccupancyMaxActiveBlocksPerMultiprocessor(&per_cu, (const void*)mk_fwd, NTHREADS, LDS_BYTES) != hipSuccess || per_cu < 1) { fprintf(stderr, "kernel_launch: occupancy query says %d\n", per_cu); per_cu = 1; }
        (void)hipGetLastError();
        grid = cus;
        if (grid % 8) grid -= grid % 8;
    }
    if (grid < 0) return;
    Args a{};
    a.x = (const float*)d_in[0]; a.w_in = (const float*)d_in[1]; a.mla_q_norm = (const float*)d_in[2]; a.mla_kv_norm = (const float*)d_in[3];
    a.w_uq = (const float*)d_in[4]; a.w_ukv = (const float*)d_in[5]; a.gqa_q_norm = (const float*)d_in[6]; a.gqa_k_norm = (const float*)d_in[7];
    a.rel_bias = (const float*)d_in[8]; a.w_out = (const float*)d_in[9]; a.ln1_g = (const float*)d_in[10]; a.ln1_b = (const float*)d_in[11];
    a.w_gate = (const float*)d_in[12]; a.w_up = (const float*)d_in[13]; a.w_down = (const float*)d_in[14]; a.ln2_g = (const float*)d_in[15]; a.ln2_b = (const float*)d_in[16];
    a.out = (float*)d_out; a.ws = (unsigned char*)d_ws;
#if MK_MULTI
    for (int ph = 0; ph < N_PHASES; ++ph) {
        a.ph_lo = ph; a.ph_hi = ph + 1;
        void* args[] = {&a};
        hipError_t e = hipLaunchCooperativeKernel((const void*)mk_fwd, dim3(grid), dim3(NTHREADS), args, LDS_BYTES, stream);
        if (e != hipSuccess) { fprintf(stderr, "kernel_launch: launch %d failed: %s\n", ph, hipGetErrorString(e)); break; }
    }
#else
    a.ph_lo = 0; a.ph_hi = N_PHASES;
    void* args[] = {&a};
    hipError_t e = hipLaunchCooperativeKernel((const void*)mk_fwd, dim3(grid), dim3(NTHREADS), args, LDS_BYTES, stream);
    if (e != hipSuccess) fprintf(stderr, "kernel_launch: cooperative launch failed: %s (grid %d)\n", hipGetErrorString(e), grid);
#endif
}
```
